# Optimizing an MI355X kernel written in HIP

```python
import math
import jax, jax.numpy as jnp
from jax import lax
import numpy as np

D_MODEL = 1024
BATCH = 4
SEQ = 4096
DEPTH = 4

CHUNK = 64
Q_BLOCK = 128
MEM_LEN = 256
FOX_HEAD_DIM = 64
FOX_WIDTH = 3 * D_MODEL // 8
FOX_HEADS = FOX_WIDTH // FOX_HEAD_DIM
MLSTM_HEADS = 4
MLSTM_WIDTH = 3 * D_MODEL // 8
MLSTM_HEAD_DIM = MLSTM_WIDTH // MLSTM_HEADS
MEM_HEADS = 4
MEM_WIDTH = D_MODEL // 4
MEM_HEAD_DIM = MEM_WIDTH // MEM_HEADS
MIX_WIDTH = FOX_WIDTH + MLSTM_WIDTH + MEM_WIDTH
CONV_WIDTH = 4
LN_EPS = 1e-5
DEEPNORM_ALPHA = (2.0 * DEPTH) ** 0.25
DEEPNORM_BETA = (8.0 * DEPTH) ** -0.25
IN_SPLITS = (FOX_WIDTH, FOX_WIDTH, FOX_WIDTH, FOX_HEADS, FOX_WIDTH,
             MLSTM_WIDTH, MLSTM_WIDTH, MLSTM_WIDTH, MLSTM_HEADS, MLSTM_HEADS, MLSTM_WIDTH, MLSTM_WIDTH,
             MEM_WIDTH, MEM_WIDTH)
IN_COLS = sum(IN_SPLITS)

kernel_name = "fox_mlstm_memory_hybrid_deepnorm"


def layer_norm(x, g, b):
    xf = x.astype(jnp.float32)
    mu = jnp.mean(xf, axis=-1, keepdims=True)
    var = jnp.mean(jnp.square(xf - mu), axis=-1, keepdims=True)
    return ((xf - mu) * lax.rsqrt(var + LN_EPS) * g + b).astype(x.dtype)


def split_heads(t, n_heads):
    B, S, W = t.shape
    return t.reshape(B, S, n_heads, W // n_heads).transpose(0, 2, 1, 3)


def forgetting_attention(q, k, v, f_pre):
    B, S, _ = q.shape
    dt = q.dtype
    qh = split_heads(q.astype(jnp.float32), FOX_HEADS) * (FOX_HEAD_DIM ** -0.5)
    kh = split_heads(k.astype(jnp.float32), FOX_HEADS)
    vh = split_heads(v.astype(jnp.float32), FOX_HEADS)
    c = jnp.cumsum(jax.nn.log_sigmoid(f_pre.astype(jnp.float32)), axis=1).transpose(0, 2, 1)
    nb = S // Q_BLOCK
    qb = qh.reshape(B, FOX_HEADS, nb, Q_BLOCK, FOX_HEAD_DIM).transpose(2, 0, 1, 3, 4)
    cb = c.reshape(B, FOX_HEADS, nb, Q_BLOCK).transpose(2, 0, 1, 3)
    starts = jnp.arange(nb, dtype=jnp.int32) * Q_BLOCK
    key_pos = jnp.arange(S, dtype=jnp.int32)

    def block(args):
        q_blk, c_blk, start = args
        logits = (jnp.einsum('bhqd,bhkd->bhqk', q_blk, kh)
                  + c_blk[..., :, None] - c[..., None, :])
        q_pos = start + jnp.arange(Q_BLOCK, dtype=jnp.int32)
        causal = key_pos[None, :] <= q_pos[:, None]
        p = jax.nn.softmax(jnp.where(causal, logits, -jnp.inf), axis=-1)
        return jnp.einsum('bhqk,bhkd->bhqd', p, vh)

    out = lax.map(block, (qb, cb, starts))
    return out.transpose(1, 0, 3, 2, 4).reshape(B, S, FOX_WIDTH).astype(dt)


def causal_depthwise_conv(u, w, b):
    C = u.shape[-1]
    y = lax.conv_general_dilated(u, w[:, None, :].astype(u.dtype), window_strides=(1,),
                                 padding=((CONV_WIDTH - 1, 0),),
                                 dimension_numbers=('NWC', 'WIO', 'NWC'),
                                 feature_group_count=C)
    return y + b


def mlstm(q, k, v, i_pre, f_pre, o_pre, norm_g):
    B, S, _ = q.shape
    dt = q.dtype
    H, dh = MLSTM_HEADS, MLSTM_HEAD_DIM
    qh = split_heads(q.astype(jnp.float32), H)
    kh = split_heads(k.astype(jnp.float32), H) * (dh ** -0.5)
    vh = split_heads(v.astype(jnp.float32), H)
    log_i = i_pre.astype(jnp.float32).transpose(0, 2, 1)
    log_f = jax.nn.log_sigmoid(f_pre.astype(jnp.float32)).transpose(0, 2, 1)
    nc = S // CHUNK

    def chunks(t):
        return jnp.moveaxis(t.reshape(B, H, nc, CHUNK, *t.shape[3:]), 2, 0)

    tril = jnp.tril(jnp.ones((CHUNK, CHUNK), dtype=bool))

    def step(carry, xs):
        C, n, m = carry
        qc, kc, vc, ic, fc = xs
        b = jnp.cumsum(fc, axis=-1)
        log_d = jnp.where(tril, b[..., :, None] - b[..., None, :] + ic[..., None, :], -jnp.inf)
        inter = b + m[..., None]
        m_row = jnp.maximum(inter, jnp.max(log_d, axis=-1))
        s = jnp.einsum('bhtd,bhsd->bhts', qc, kc) * jnp.exp(log_d - m_row[..., None])
        dec = jnp.exp(inter - m_row)
        num = (jnp.einsum('bhts,bhse->bhte', s, vc)
               + dec[..., None] * jnp.einsum('bhtd,bhed->bhte', qc, C))
        den = jnp.sum(s, axis=-1) + dec * jnp.einsum('bhtd,bhd->bht', qc, n)
        h = num / jnp.maximum(jnp.abs(den), jnp.exp(-m_row))[..., None]
        b_last = b[..., -1]
        log_w = b_last[..., None] - b + ic
        m_new = jnp.maximum(b_last + m, jnp.max(log_w, axis=-1))
        w = jnp.exp(log_w - m_new[..., None])
        carry_dec = jnp.exp(b_last + m - m_new)
        C_new = carry_dec[..., None, None] * C + jnp.einsum('bhs,bhse,bhsd->bhed', w, vc, kc)
        n_new = carry_dec[..., None] * n + jnp.einsum('bhs,bhsd->bhd', w, kc)
        return (C_new, n_new, m_new), h

    init = (jnp.zeros((B, H, dh, dh), jnp.float32), jnp.zeros((B, H, dh), jnp.float32),
            jnp.zeros((B, H), jnp.float32))
    _, h = lax.scan(step, init, (chunks(qh), chunks(kh), chunks(vh), chunks(log_i), chunks(log_f)))
    h = jnp.moveaxis(h, 0, 2).reshape(B, H, S, dh).transpose(0, 2, 1, 3)
    h = jax.nn.sigmoid(o_pre.astype(jnp.float32)).reshape(B, S, H, dh) * h
    mu = jnp.mean(h, axis=-1, keepdims=True)
    var = jnp.mean(jnp.square(h - mu), axis=-1, keepdims=True)
    h = ((h - mu) * lax.rsqrt(var + LN_EPS)).reshape(B, S, MLSTM_WIDTH) * norm_g
    return h.astype(dt)


def memory_attention(q, mem_k, mem_v):
    B, S, _ = q.shape
    dt = q.dtype
    qh = split_heads(q.astype(jnp.float32), MEM_HEADS) * (MEM_HEAD_DIM ** -0.5)
    kh = split_heads(mem_k.astype(jnp.float32), MEM_HEADS)
    vh = split_heads(mem_v.astype(jnp.float32), MEM_HEADS)
    p = jax.nn.softmax(jnp.einsum('bhsd,bhmd->bhsm', qh, kh), axis=-1)
    out = jnp.einsum('bhsm,bhmd->bhsd', p, vh)
    return out.transpose(0, 2, 1, 3).reshape(B, S, MEM_WIDTH).astype(dt)


def hybrid_layer(x, mem, w_in, fox_f_bias, conv_w, conv_b, i_bias, f_bias, norm_g,
                 w_mem_kv, w_out, ln_g, ln_b):
    u = x @ w_in
    split_points = np.cumsum(IN_SPLITS)[:-1].tolist()
    (fq, fk, fv, ff, fz, mq, mk, mv, mi, mf, mo, mz, rq, rz) = jnp.split(u, split_points, axis=-1)
    y_fox = forgetting_attention(fq, fk, fv, ff + fox_f_bias) * jax.nn.silu(fz)
    qk = jax.nn.silu(causal_depthwise_conv(jnp.concatenate([mq, mk], axis=-1), conv_w, conv_b))
    mq_c, mk_c = jnp.split(qk, [MLSTM_WIDTH], axis=-1)
    y_ml = mlstm(mq_c, mk_c, mv, mi + i_bias, mf + f_bias, mo, norm_g) * jax.nn.silu(mz)
    mem_k, mem_v = jnp.split(mem @ w_mem_kv, [MEM_WIDTH], axis=-1)
    y_mem = memory_attention(rq, mem_k, mem_v) * jax.nn.silu(rz)
    y = jnp.concatenate([y_fox, y_ml, y_mem], axis=-1) @ w_out
    return layer_norm(DEEPNORM_ALPHA * x + y, ln_g, ln_b)


def setup_inputs(seed: int = 0) -> dict:
    key = jax.random.key(seed)
    ks = jax.random.split(key, 16)
    f32 = jnp.float32
    x = jax.random.normal(ks[0], (BATCH, SEQ, D_MODEL), f32)
    mem = jax.random.normal(ks[1], (BATCH, MEM_LEN, D_MODEL), f32)
    w_in = jax.random.normal(ks[2], (DEPTH, D_MODEL, IN_COLS), f32) * D_MODEL ** -0.5
    fox_f_bias = (jnp.linspace(1.0, 6.0, FOX_HEADS, dtype=f32)[None, :]
                  + 0.1 * jax.random.normal(ks[3], (DEPTH, FOX_HEADS), f32))
    mlstm_conv_w = jax.random.normal(ks[4], (DEPTH, CONV_WIDTH, 2 * MLSTM_WIDTH), f32) * CONV_WIDTH ** -0.5
    mlstm_conv_b = 0.01 * jax.random.normal(ks[5], (DEPTH, 2 * MLSTM_WIDTH), f32)
    mlstm_i_bias = 0.1 * jax.random.normal(ks[6], (DEPTH, MLSTM_HEADS), f32)
    mlstm_f_bias = (jnp.linspace(3.0, 6.0, MLSTM_HEADS, dtype=f32)[None, :]
                    + 0.1 * jax.random.normal(ks[7], (DEPTH, MLSTM_HEADS), f32))
    mlstm_norm_g = 1.0 + 0.02 * jax.random.normal(ks[8], (DEPTH, MLSTM_WIDTH), f32)
    w_mem_kv = jax.random.normal(ks[9], (DEPTH, D_MODEL, 2 * MEM_WIDTH), f32) * D_MODEL ** -0.5
    w_out = (jax.random.normal(ks[10], (DEPTH, MIX_WIDTH, D_MODEL), f32)
             * (MIX_WIDTH ** -0.5) * DEEPNORM_BETA)
    ln_g = 1.0 + 0.02 * jax.random.normal(ks[11], (DEPTH, D_MODEL), f32)
    ln_b = 0.02 * jax.random.normal(ks[12], (DEPTH, D_MODEL), f32)
    return {"x": x, "mem": mem, "w_in": w_in, "fox_f_bias": fox_f_bias,
            "mlstm_conv_w": mlstm_conv_w, "mlstm_conv_b": mlstm_conv_b,
            "mlstm_i_bias": mlstm_i_bias, "mlstm_f_bias": mlstm_f_bias,
            "mlstm_norm_g": mlstm_norm_g, "w_mem_kv": w_mem_kv, "w_out": w_out,
            "ln_g": ln_g, "ln_b": ln_b}


def reference(x, mem, w_in, fox_f_bias, mlstm_conv_w, mlstm_conv_b, mlstm_i_bias, mlstm_f_bias,
              mlstm_norm_g, w_mem_kv, w_out, ln_g, ln_b):
    for l in range(DEPTH):
        x = hybrid_layer(x, mem, w_in[l], fox_f_bias[l], mlstm_conv_w[l], mlstm_conv_b[l],
                         mlstm_i_bias[l], mlstm_f_bias[l], mlstm_norm_g[l], w_mem_kv[l],
                         w_out[l], ln_g[l], ln_b[l])
    return x
```

```cpp
#include <hip/hip_runtime.h>
#include <hip/hip_cooperative_groups.h>
#include <cstdio>
#include <cstdint>
namespace cg = cooperative_groups;
__device__ __forceinline__ int fresh_tid() { int t = threadIdx.x; asm volatile("" : "+v"(t)); return t; }
namespace pg8 {
#define PG8_LAS __attribute__((address_space(3)))
typedef unsigned short bf16_t;
typedef short bf16x8 __attribute__((ext_vector_type(8)));
typedef float f32x4 __attribute__((ext_vector_type(4)));
typedef unsigned u32x4 __attribute__((ext_vector_type(4)));
constexpr int BM = 256, BK = 64, HALF = 128, HTB = HALF * BK * 2  , STAGE_BYTES = 8 * HTB, NXCD = 8, WGM = 8;

__host__ __device__ __forceinline__ int lds_byte(int r, int c) { const int st = (r >> 4) * 2 + (c >> 5), rr = r & 15, cc = c & 31, ob = rr * 64 + cc * 2; return st * 1024 + (ob ^ (((ob >> 9) & 1) << 5)); }
__host__ __device__ __forceinline__ void stage_rc(int b, int& R, int& C) { const int st = b / 1024, sb = b % 1024, swz = sb ^ (((sb >> 9) & 1) << 5); R = (st >> 1) * 16 + swz / 64; C = (st & 1) * 32 + (swz % 64) / 2; }
__host__ __device__ __forceinline__ int perm32(int rho) { const int n = rho >> 4, i = rho & 15; return 8 * (i >> 2) + 4 * n + (i & 3); }

struct Unit { int pm, pn; };
struct Gemm { const bf16_t* A; const bf16_t* Bt; int M, N, K; };

struct StaticOrder {
    int nM, nN, nwg, G, c;
    __host__ __device__ void init(int M, int N, int G_, int c_) { nM = M / BM; nN = N / BM; nwg = nM * nN; G = G_; c = c_; }
    __host__ __device__ bool next(int i, Unit& u) const {
        const long L = (long)i * G + c; if (L >= nwg) return false;
        int wgid = (int)L; { const int q = nwg / NXCD, r = nwg % NXCD, xcd = wgid % NXCD, off = wgid / NXCD; wgid = (xcd < r ? xcd * (q + 1) : r * (q + 1) + (xcd - r) * q) + off; }
        const int nig = WGM * nN, gid = wgid / nig, fm = gid * WGM, gsz = (nM - fm) < WGM ? (nM - fm) : WGM;
        u.pm = fm + ((wgid % nig) % gsz); u.pn = (wgid % nig) / gsz; return true;
    }
    __device__ __forceinline__ void a_ready(const Unit&) const {}
    __device__ __forceinline__ void done(const Unit&) const {}
};

__device__ __forceinline__ unsigned cvt_pk_bf16(float lo, float hi) { unsigned r; asm volatile("v_cvt_pk_bf16_f32 %0, %1, %2" : "=v"(r) : "v"(lo), "v"(hi)); return r; }
typedef float f32x2 __attribute__((ext_vector_type(2)));
__device__ __forceinline__ f32x2 gelu_pk(f32x2 v) {
    const f32x2 av = __builtin_elementwise_abs(v), d = av * 0.2316418882f + 1.0f;
    f32x2 t; t.x = __builtin_amdgcn_rcpf(d.x); t.y = __builtin_amdgcn_rcpf(d.y);
    f32x2 q = t * 0.5307027145f + (-0.7265760135f); q = q * t + 0.7107068705f; q = q * t + (-0.142248368f); q = q * t + 0.127414796f; q = q * t;
    const f32x2 s = (v * v) * (-0.72134752044f);
    f32x2 e; e.x = __builtin_amdgcn_exp2f(s.x); e.y = __builtin_amdgcn_exp2f(s.y);
    const f32x2 m = v * (q * e), r = v - m;
    f32x2 o; o.x = v.x < 0.f ? m.x : r.x; o.y = v.y < 0.f ? m.y : r.y; return o;
}

template <int ACT  > struct EpiBf16 {
    static constexpr bool PERM = true, AFTER_DRAIN = false; static_assert(ACT == 0 || ACT == 1, "EpiBf16: ACT is 0 (none) or 1 (gelu_pk)");
    bf16_t* O; int ldc; const float* bias; int split_cols; size_t split_stride; float scale0;
    __device__ __forceinline__ void operator()(const f32x4 (&acc)[2][2][4][2], const Unit& u, int wr, int wc, int fr, int fq) const {
        const int row0 = u.pm * BM + wr * 64 + fr; int colt = u.pn * BM; bf16_t* base = O;
        float sc = 1.f; if (split_cols) { const int t = colt / split_cols; base += (size_t)t * split_stride; colt -= t * split_cols; if (t == 0) sc = scale0; }
        const int col0 = colt + wc * 32 + 8 * fq, bcol0 = u.pn * BM + wc * 32 + 8 * fq;
        f32x4 bv[2][2];
#pragma unroll
        for (int bj = 0; bj < 2; ++bj)
#pragma unroll
            for (int n = 0; n < 2; ++n) bv[bj][n] = bias ? *(const f32x4*)(bias + bcol0 + bj * HALF + 4 * n) : (f32x4){0.f, 0.f, 0.f, 0.f};
#pragma unroll
        for (int ai = 0; ai < 2; ++ai)
#pragma unroll
            for (int m = 0; m < 4; ++m) { bf16_t* rowp = base + (size_t)(row0 + ai * HALF + m * 16) * ldc + col0;
#pragma unroll
                for (int bj = 0; bj < 2; ++bj) { f32x4 v0 = acc[ai][bj][m][0] + bv[bj][0], v1 = acc[ai][bj][m][1] + bv[bj][1];
                    if (ACT == 1) { f32x2 a = gelu_pk((f32x2){v0[0], v0[1]}), b = gelu_pk((f32x2){v0[2], v0[3]}), c = gelu_pk((f32x2){v1[0], v1[1]}), d = gelu_pk((f32x2){v1[2], v1[3]});
                        v0 = (f32x4){a.x, a.y, b.x, b.y}; v1 = (f32x4){c.x, c.y, d.x, d.y}; }
                    v0 = v0 * sc; v1 = v1 * sc; u32x4 w; w.x = cvt_pk_bf16(v0[0], v0[1]); w.y = cvt_pk_bf16(v0[2], v0[3]); w.z = cvt_pk_bf16(v1[0], v1[1]); w.w = cvt_pk_bf16(v1[2], v1[3]);
                    *(u32x4*)(rowp + bj * HALF) = w; } }
    }
};
struct EpiF32 {
    static constexpr bool PERM = false, AFTER_DRAIN = false;
    float* O; int ldc;
    __device__ __forceinline__ void operator()(const f32x4 (&acc)[2][2][4][2], const Unit& u, int wr, int wc, int fr, int fq) const {
        const int row0 = u.pm * BM + wr * 64 + fr, col0 = u.pn * BM + wc * 32 + 4 * fq;
#pragma unroll
        for (int ai = 0; ai < 2; ++ai)
#pragma unroll
            for (int m = 0; m < 4; ++m) { float* rowp = O + (size_t)(row0 + ai * HALF + m * 16) * ldc + col0;
#pragma unroll
                for (int bj = 0; bj < 2; ++bj)
#pragma unroll
                    for (int n = 0; n < 2; ++n) *(f32x4*)(rowp + bj * HALF + n * 16) = acc[ai][bj][m][n]; }
    }
};
struct EpiU {
    static constexpr bool PERM = true, AFTER_DRAIN = false;
    bf16_t* O; float* G;
    __device__ __forceinline__ void operator()(const f32x4 (&acc)[2][2][4][2], const Unit& u, int wr, int wc, int fr, int fq) const {
        const int row0 = u.pm * BM + wr * 64 + fr, col0 = u.pn * BM + wc * 32 + 8 * fq;
#pragma unroll
        for (int ai = 0; ai < 2; ++ai)
#pragma unroll
            for (int m = 0; m < 4; ++m) { bf16_t* rowp = O + (size_t)(row0 + ai * HALF + m * 16) * 4096 + col0;
#pragma unroll
                for (int bj = 0; bj < 2; ++bj) { const f32x4 v0 = acc[ai][bj][m][0], v1 = acc[ai][bj][m][1];
                    u32x4 w; w.x = cvt_pk_bf16(v0[0], v0[1]); w.y = cvt_pk_bf16(v0[2], v0[3]); w.z = cvt_pk_bf16(v1[0], v1[1]); w.w = cvt_pk_bf16(v1[2], v1[3]);
                    *(u32x4*)(rowp + bj * HALF) = w; } }
        if (u.pn == 15 && wc == 0 && fq < 2) {
#pragma unroll
            for (int ai = 0; ai < 2; ++ai)
#pragma unroll
                for (int m = 0; m < 4; ++m) { float* gp = G + (size_t)(row0 + ai * HALF + m * 16) * 16 + 8 * fq;
                    *(f32x4*)(gp) = acc[ai][1][m][0]; *(f32x4*)(gp + 4) = acc[ai][1][m][1]; }
        }
    }
};
template <class Epi, class Sched, bool ALIGN_EPI = false, bool SP2 = false>
__device__ __forceinline__ void gemm_phase(PG8_LAS unsigned char* lds, const Gemm g, const Sched& S, const Epi& E) {
    const int tid = fresh_tid(), wid = __builtin_amdgcn_readfirstlane(tid >> 6), lane = tid & 63, wr = wid >> 2, wc = wid & 3, fr = lane & 15, fq = lane >> 4;
    const int K = g.K, nt = K / BK;
    unsigned voffA[2], voffB[2];
#pragma unroll
    for (int i = 0; i < 2; ++i) { int R, C; stage_rc(tid * 16 + i * 8192, R, C); const int Rb = Epi::PERM ? ((R & ~31) + perm32(R & 31)) : R;
        voffA[i] = (unsigned)(R * K + C) * 2u; voffB[i] = (unsigned)(Rb * K + C) * 2u; }
    const size_t kstep = (size_t)(BK * 2);
    const size_t hstep = (size_t)HALF * K * 2;
    const size_t tstep = 2 * hstep;
    const unsigned ldsw = (unsigned)wid * 1024u;
    const int aoff = lds_byte(wr * 64 + fr, fq * 8), boff = lds_byte(wc * 32 + fr, fq * 8);
#define PG8_SA(b, h) (((b) * 2 + (h)) * HTB)
#define PG8_SB(b, h) ((4 + (b) * 2 + (h)) * HTB)
#define PG8_STAGE(bufoff, gbase, voff) do { _Pragma("unroll") for (int _i = 0; _i < 2; ++_i) \
        __builtin_amdgcn_global_load_lds((const unsigned*)((const char*)(gbase) + (voff)[_i]), (PG8_LAS unsigned*)(lds + (bufoff) + ldsw + _i * 8192), 16, 0, 0); } while (0)
#define PG8_LDA(dst, b, h) do { _Pragma("unroll") for (int m = 0; m < 4; ++m) _Pragma("unroll") for (int k = 0; k < 2; ++k) dst[m][k] = *(const PG8_LAS bf16x8*)(lds + PG8_SA(b, h) + aoff + m * 2048 + k * 1024); } while (0)
#define PG8_LDB(dst, b, h) do { _Pragma("unroll") for (int n = 0; n < 2; ++n) _Pragma("unroll") for (int k = 0; k < 2; ++k) dst[n][k] = *(const PG8_LAS bf16x8*)(lds + PG8_SB(b, h) + boff + n * 2048 + k * 1024); } while (0)
#define PG8_MMA(ai, bj, At, Bt) do { __builtin_amdgcn_s_setprio(1); _Pragma("unroll") for (int m = 0; m < 4; ++m) _Pragma("unroll") for (int n = 0; n < 2; ++n) _Pragma("unroll") for (int k = 0; k < 2; ++k) \
        acc[ai][bj][m][n] = __builtin_amdgcn_mfma_f32_16x16x32_bf16(Bt[n][k], At[m][k], acc[ai][bj][m][n], 0, 0, 0); __builtin_amdgcn_s_setprio(0); } while (0)
#define PG8_WAIT_V(n) asm volatile("s_waitcnt vmcnt(" #n ")" ::: "memory")
#define PG8_WAIT_L(n) asm volatile("s_waitcnt lgkmcnt(" #n ")" ::: "memory")
#define PG8_BAR __builtin_amdgcn_s_barrier()
#define PG8_SCHED __builtin_amdgcn_sched_barrier(0)
    Unit cur, nxt; int ui = 0;
    if (!S.next(0, cur)) return;
    f32x4 acc[2][2][4][2];
#pragma unroll
    for (int a = 0; a < 2; ++a)
#pragma unroll
        for (int b = 0; b < 2; ++b)
#pragma unroll
            for (int m = 0; m < 4; ++m)
#pragma unroll
                for (int n = 0; n < 2; ++n) acc[a][b][m][n] = (f32x4){0.f, 0.f, 0.f, 0.f};
    bf16x8 At[4][2], B0[2][2], B1[2][2];
    const char* cA = (const char*)g.A + (size_t)cur.pm * tstep; const char* cB = (const char*)g.Bt + (size_t)cur.pn * tstep;
    S.a_ready(cur);
    if constexpr (SP2) {
        PG8_STAGE(PG8_SB(0, 0), cB, voffB); PG8_STAGE(PG8_SB(0, 1), cB + hstep, voffB); PG8_STAGE(PG8_SA(0, 0), cA, voffA); PG8_STAGE(PG8_SA(0, 1), cA + hstep, voffA);
        if (wr == 1) PG8_BAR;
        PG8_WAIT_V(2); PG8_BAR;
        PG8_STAGE(PG8_SB(1, 0), cB + kstep, voffB); PG8_STAGE(PG8_SA(1, 0), cA + kstep, voffA); PG8_STAGE(PG8_SB(1, 1), cB + hstep + kstep, voffB);
        PG8_WAIT_V(6); PG8_BAR;
    } else {
        PG8_STAGE(PG8_SB(0, 0), cB, voffB); PG8_STAGE(PG8_SA(0, 0), cA, voffA); PG8_STAGE(PG8_SB(0, 1), cB + hstep, voffB); PG8_STAGE(PG8_SA(0, 1), cA + hstep, voffA);
        if (wr == 1) PG8_BAR;
        PG8_WAIT_V(4); PG8_BAR;
        PG8_STAGE(PG8_SB(1, 0), cB + kstep, voffB); PG8_STAGE(PG8_SA(1, 0), cA + kstep, voffA); PG8_STAGE(PG8_SB(1, 1), cB + hstep + kstep, voffB);
        PG8_WAIT_V(6); PG8_BAR;
    }
    for (;;) {
        const bool has_next = S.next(ui + 1, nxt);
        const char* nA = has_next ? (const char*)g.A + (size_t)nxt.pm * tstep : cA; const char* nB = has_next ? (const char*)g.Bt + (size_t)nxt.pn * tstep : cB;
        for (int t = 0; t < nt; t += 2) {
            const bool last = (t == nt - 2);
            const char* a1 = cA + (size_t)(t + 1) * kstep;
            const char* a2 = last ? nA : cA + (size_t)(t + 2) * kstep; const char* b2 = last ? nB : cB + (size_t)(t + 2) * kstep;
            const char* a3 = a2 + kstep; const char* b3 = b2 + kstep;
            if (last && has_next) S.a_ready(nxt);
            if constexpr (SP2) {
            PG8_LDB(B0, 0, 0); PG8_LDB(B1, 0, 1); PG8_SCHED; PG8_LDA(At, 0, 0); PG8_STAGE(PG8_SA(1, 1), a1 + hstep, voffA);
            PG8_WAIT_V(8); PG8_WAIT_L(0); PG8_BAR; PG8_MMA(0, 0, At, B0); PG8_MMA(0, 1, At, B1); PG8_BAR; PG8_SCHED;
            PG8_LDA(At, 0, 1); PG8_STAGE(PG8_SB(0, 0), b2, voffB); PG8_STAGE(PG8_SB(0, 1), b2 + hstep, voffB); PG8_STAGE(PG8_SA(0, 0), a2, voffA);
            PG8_WAIT_V(8); PG8_WAIT_L(0); PG8_BAR; PG8_MMA(1, 0, At, B0); PG8_MMA(1, 1, At, B1); PG8_BAR; PG8_SCHED;
            PG8_LDB(B0, 1, 0); PG8_LDB(B1, 1, 1); PG8_SCHED; PG8_LDA(At, 1, 0); PG8_STAGE(PG8_SA(0, 1), a2 + hstep, voffA);
            PG8_WAIT_V(8); PG8_WAIT_L(0); PG8_BAR; PG8_MMA(0, 0, At, B0); PG8_MMA(0, 1, At, B1); PG8_BAR; PG8_SCHED;
            PG8_LDA(At, 1, 1); PG8_STAGE(PG8_SB(1, 0), b3, voffB); PG8_STAGE(PG8_SB(1, 1), b3 + hstep, voffB); PG8_STAGE(PG8_SA(1, 0), a3, voffA);
            PG8_WAIT_V(8); PG8_WAIT_L(0); PG8_BAR; PG8_MMA(1, 0, At, B0); PG8_MMA(1, 1, At, B1); PG8_BAR; PG8_SCHED;
            } else {
            PG8_LDB(B0, 0, 0); PG8_SCHED; PG8_LDA(At, 0, 0); PG8_STAGE(PG8_SA(1, 1), a1 + hstep, voffA);
            PG8_WAIT_L(8); PG8_BAR; PG8_WAIT_L(0); PG8_MMA(0, 0, At, B0); PG8_BAR; PG8_SCHED;
            PG8_LDB(B1, 0, 1); PG8_STAGE(PG8_SB(0, 0), b2, voffB);
            PG8_BAR; PG8_WAIT_L(0); PG8_MMA(0, 1, At, B1); PG8_BAR;
            PG8_LDA(At, 0, 1); PG8_STAGE(PG8_SA(0, 0), a2, voffA);
            PG8_BAR; PG8_WAIT_L(0); PG8_MMA(1, 0, At, B0); PG8_BAR; PG8_SCHED;
            PG8_STAGE(PG8_SB(0, 1), b2 + hstep, voffB);
            PG8_WAIT_V(6); PG8_BAR; PG8_MMA(1, 1, At, B1); PG8_BAR;
            PG8_LDB(B0, 1, 0); PG8_SCHED; PG8_LDA(At, 1, 0); PG8_STAGE(PG8_SA(0, 1), a2 + hstep, voffA);
            PG8_WAIT_L(8); PG8_BAR; PG8_WAIT_L(0); PG8_MMA(0, 0, At, B0); PG8_BAR; PG8_SCHED;
            PG8_LDB(B1, 1, 1); PG8_STAGE(PG8_SB(1, 0), b3, voffB);
            PG8_BAR; PG8_WAIT_L(0); PG8_MMA(0, 1, At, B1); PG8_BAR;
            PG8_LDA(At, 1, 1); PG8_STAGE(PG8_SA(1, 0), a3, voffA);
            PG8_BAR; PG8_WAIT_L(0); PG8_MMA(1, 0, At, B0); PG8_BAR; PG8_SCHED;
            PG8_STAGE(PG8_SB(1, 1), b3 + hstep, voffB);
            PG8_WAIT_V(6); PG8_BAR; PG8_MMA(1, 1, At, B1); PG8_BAR;
            }
        }
        if constexpr (ALIGN_EPI) { if (wr == 0) PG8_BAR; }
        if constexpr (!Epi::AFTER_DRAIN) { E(acc, cur, wr, wc, fr, fq); S.done(cur); }
        if (!has_next) break;
#pragma unroll
        for (int a = 0; a < 2; ++a)
#pragma unroll
            for (int b = 0; b < 2; ++b)
#pragma unroll
                for (int m = 0; m < 4; ++m)
#pragma unroll
                    for (int n = 0; n < 2; ++n) acc[a][b][m][n] = (f32x4){0.f, 0.f, 0.f, 0.f};
        cur = nxt; cA = nA; cB = nB; ++ui;
        if constexpr (ALIGN_EPI) { if (wr == 1) PG8_BAR; }
    }
    PG8_WAIT_V(0);
    if constexpr (!ALIGN_EPI) { if (wr == 0) PG8_BAR; }
    PG8_BAR;
    if constexpr (Epi::AFTER_DRAIN) { E.fused(acc, cur, wr, wc, fr, fq, lds, wid, lane); S.done(cur); }
#undef PG8_SA
#undef PG8_SB
#undef PG8_STAGE
#undef PG8_LDA
#undef PG8_LDB
#undef PG8_MMA
#undef PG8_WAIT_V
#undef PG8_WAIT_L
#undef PG8_BAR
#undef PG8_SCHED
}
}
#define PG8_SP2 true
#include <hip/hip_bf16.h>
#include <cmath>
namespace attn_body {
using bf16=__hip_bfloat16;
using bf16x8=__attribute__((ext_vector_type(8)))short;
using s16x4=__attribute__((ext_vector_type(4)))short;
using f32x16=__attribute__((ext_vector_type(16)))float;
using u32x4=__attribute__((ext_vector_type(4)))unsigned;
using f32x4_t=__attribute__((ext_vector_type(4)))float;
constexpr int BATCH=4,NHEAD=6,SEQ=4096,D=64,DM=4096,OPITCH=1024;
constexpr int NW=8,QBLK=32,QB=QBLK*NW,KVBLK=64,NQB=SEQ/QB;
constexpr int ATTN_PITCH=DM, ATTN_UNIT_ROWS=QB;
__device__ __forceinline__ int crow(int r,int hi){return (r&3)+8*(r>>2)+4*hi;}
#define SBAR() __builtin_amdgcn_sched_barrier(0)
__device__ __forceinline__ void cmask(f32x16&p0,f32x16&p1,int jb,int qrel,int hi){
  const float NEG=-INFINITY; int kb=64*jb+4*hi;
  #pragma unroll
  for(int r=0;r<16;++r){int kv=kb+(r&3)+8*(r>>2); if(kv>qrel)p0[r]=NEG; if(kv+32>qrel)p1[r]=NEG;}
}

constexpr int NSLOT=3, SLOTB=8192;
constexpr int LDS_K=0, LDS_V=NSLOT*SLOTB, LDS_WS=2*NSLOT*SLOTB, LDS_OST=LDS_WS+NW*64*4, LDS_NB=LDS_OST+NW*4096, LDS_BYTES=LDS_NB+SEQ*4+64;
constexpr float C2=0.125f*1.4426950408889634f;
__device__ __forceinline__ void glds16(const void*gsrc,unsigned lds_dst){unsigned keep;
  asm volatile("s_mov_b32 %0, m0\n\ts_mov_b32 m0, %2\n\ts_nop 0\n\tglobal_load_lds_dwordx4 %1, off\n\ts_mov_b32 m0, %0":"=&s"(keep):"v"(gsrc),"s"(lds_dst):"memory");}
__device__ __forceinline__ float max3f(float a,float b,float c){float r;asm("v_max3_f32 %0, %1, %2, %3":"=v"(r):"v"(a),"v"(b),"v"(c));return r;}
__device__ __forceinline__ float max2f(float a,float b){float r;asm("v_max_f32_e32 %0, %1, %2":"=v"(r):"v"(a),"v"(b));return r;}
__device__ __forceinline__ float fadd_s(float a,float b){float r;asm("v_add_f32_e32 %0, %1, %2":"=v"(r):"v"(a),"v"(b));return r;}
__device__ __forceinline__ float fsub_s(float a,float b){float r;asm("v_sub_f32_e32 %0, %1, %2":"=v"(r):"v"(a),"v"(b));return r;}
typedef float f32x2_t __attribute__((ext_vector_type(2))); typedef __bf16 bf16x2_t __attribute__((ext_vector_type(2)));
__device__ __forceinline__ unsigned cvtpk_s(float lo,float hi){f32x2_t v={lo,hi};bf16x2_t b=__builtin_convertvector(v,bf16x2_t);return __builtin_bit_cast(unsigned,b);}
#define WAIT_BAR(N) asm volatile("s_waitcnt vmcnt(" #N ") lgkmcnt(0)\n\ts_barrier":::"memory")

__device__ __forceinline__ void qkt(f32x16&p0,f32x16&p1,const char*Kslot,const bf16x8*qr,int r32,int hi){
  const char*kb=Kslot+hi*1024+r32*16;
  #pragma unroll
  for(int d0=0;d0<4;++d0){
    const bf16x8 b0=*reinterpret_cast<const bf16x8*>(kb+d0*2048);
    const bf16x8 b1=*reinterpret_cast<const bf16x8*>(kb+d0*2048+512);
    if(d0==0){p0=__builtin_amdgcn_mfma_f32_32x32x16_bf16(b0,qr[0],p0,0,0,0);p1=__builtin_amdgcn_mfma_f32_32x32x16_bf16(b1,qr[0],p1,0,0,0);}
    else{p0=__builtin_amdgcn_mfma_f32_32x32x16_bf16(b0,qr[d0],p0,0,0,0);p1=__builtin_amdgcn_mfma_f32_32x32x16_bf16(b1,qr[d0],p1,0,0,0);}}
}
typedef __attribute__((address_space(3))) const char* lds_cptr;
typedef short v4i16_t __attribute__((ext_vector_type(4)));
__device__ __forceinline__ void kload8(bf16x8*kf,lds_cptr kp){
  kf[0]=*(const __attribute__((address_space(3))) bf16x8*)(kp);      kf[1]=*(const __attribute__((address_space(3))) bf16x8*)(kp+512);
  kf[2]=*(const __attribute__((address_space(3))) bf16x8*)(kp+2048); kf[3]=*(const __attribute__((address_space(3))) bf16x8*)(kp+2560);
  kf[4]=*(const __attribute__((address_space(3))) bf16x8*)(kp+4096); kf[5]=*(const __attribute__((address_space(3))) bf16x8*)(kp+4608);
  kf[6]=*(const __attribute__((address_space(3))) bf16x8*)(kp+6144); kf[7]=*(const __attribute__((address_space(3))) bf16x8*)(kp+6656);
}
__device__ __forceinline__ void kload2(bf16x8*kf,lds_cptr kp,int j){ kf[2*j]=*(const __attribute__((address_space(3))) bf16x8*)(kp+j*2048); kf[2*j+1]=*(const __attribute__((address_space(3))) bf16x8*)(kp+j*2048+512); }
__device__ __forceinline__ s16x4 vtr(lds_cptr p){ return __builtin_bit_cast(s16x4,__builtin_amdgcn_ds_read_tr16_b64_v4i16((__attribute__((address_space(3))) v4i16_t*)p)); }
__device__ __forceinline__ float rowmax(const f32x16&p0,const f32x16&p1){
  float a=max3f(p0[0],p0[1],p1[0]),b=max3f(p0[2],p0[3],p1[1]);a=max3f(a,p1[2],p1[3]);
  #pragma unroll
  for(int r=4;r<16;r+=4){a=max3f(a,p0[r],p0[r+1]);b=max3f(b,p0[r+2],p0[r+3]);a=max3f(a,p1[r],p1[r+1]);b=max3f(b,p1[r+2],p1[r+3]);}
  const float m=max2f(a,b);
  auto rr=__builtin_amdgcn_permlane32_swap(__float_as_uint(m),__float_as_uint(m),false,false);
  return max2f(__uint_as_float(rr[0]),__uint_as_float(rr[1]));
}
__device__ __forceinline__ void pv(f32x16*o,int vb,bf16x8 pa0,bf16x8 pa1,bf16x8 pa2,bf16x8 pa3){
  #pragma unroll
  for(int d0=0;d0<2;++d0){s16x4 lo[4],hi[4];
    #pragma unroll
    for(int ks=0;ks<4;++ks){
      asm volatile("ds_read_b64_tr_b16 %0,%1 offset:%c2":"=&v"(lo[ks]):"v"(vb),"i"(d0*4096+ks*1024):"memory");
      asm volatile("ds_read_b64_tr_b16 %0,%1 offset:%c2":"=&v"(hi[ks]):"v"(vb),"i"(d0*4096+ks*1024+512):"memory");}
    asm volatile("s_waitcnt lgkmcnt(0)":::"memory");SBAR();
    #define PK(k) (bf16x8){lo[k][0],lo[k][1],lo[k][2],lo[k][3],hi[k][0],hi[k][1],hi[k][2],hi[k][3]}
    o[d0]=__builtin_amdgcn_mfma_f32_32x32x16_bf16(pa0,PK(0),o[d0],0,0,0);
    o[d0]=__builtin_amdgcn_mfma_f32_32x32x16_bf16(pa1,PK(1),o[d0],0,0,0);
    o[d0]=__builtin_amdgcn_mfma_f32_32x32x16_bf16(pa2,PK(2),o[d0],0,0,0);
    o[d0]=__builtin_amdgcn_mfma_f32_32x32x16_bf16(pa3,PK(3),o[d0],0,0,0);
    #undef PK
  }
}

#ifndef ATTN_STORE16
#define ATTN_STORE16(p,v) (*(u32x4*)(p)=(v))
#endif
template<int THRL> __device__ __forceinline__ void attn_unit(int b,int h,int qb,const bf16*Q,const bf16*__restrict__ K,const bf16*__restrict__ V,const bf16*__restrict__ Zg,bf16*O,char*shm,const float*__restrict__ Gf,float fbias){
  const int tid=fresh_tid(),lane=tid&63,r32=lane&31,hi=lane>>5; const int wid=__builtin_amdgcn_readfirstlane(tid>>6);
  const long rowbase=(long)b*SEQ; const int q0=qb*QB;
  typedef __attribute__((address_space(3))) float lds_f32;
  lds_f32*nbl=(lds_f32*)((__attribute__((address_space(3))) char*)shm+LDS_NB);
  { lds_f32*wt=nbl+SEQ;
    const int nkeys=q0+QB; const int i0=tid*8; float pv8[8]; float run=0.f;
    if(i0<nkeys){
      _Pragma("unroll") for(int j=0;j<8;++j){ const float xg=Gf[(rowbase+i0+j)*16+h]+fbias; const float ls=fminf(xg,0.f)-log1pf(__expf(-fabsf(xg))); run+=ls; pv8[j]=run; }
    } else { _Pragma("unroll") for(int j=0;j<8;++j)pv8[j]=0.f; }
    float sc=run;
    _Pragma("unroll") for(int o_=1;o_<64;o_<<=1){ const float v_=__shfl_up(sc,o_); if(lane>=o_)sc+=v_; }
    if(lane==63)wt[wid]=sc;
    asm volatile("s_waitcnt lgkmcnt(0)\n\ts_barrier":::"memory");
    float off=sc-run, tot=0.f;
    _Pragma("unroll") for(int w_=0;w_<8;++w_){ const float t_=wt[w_]; if(w_<wid)off+=t_; tot+=t_; }
    if(i0<nkeys){ _Pragma("unroll") for(int j=0;j<8;++j)nbl[i0+j]=(tot-(off+pv8[j]))*1.4426950408889634f; }
    asm volatile("s_waitcnt lgkmcnt(0)\n\ts_barrier":::"memory");
  }
  const bf16*Qw=Q+(rowbase+q0+wid*QBLK)*DM+h*D;
  const bf16*Kh=K+rowbase*DM+h*D,*Vh=V+rowbase*DM+h*D;
  const unsigned lds0=(unsigned)(uintptr_t)shm;
  float*wsf=(float*)(shm+LDS_WS)+wid*64;
  const bf16*ksrc=Kh+(long)lane*DM+wid*8;
  const bf16*vsrc=Vh+(long)(16*(wid&3)+(lane>>2))*DM+(wid>>2)*32+(lane&3)*8;
  const unsigned kdst=lds0+LDS_K+wid*1024, vdst=lds0+LDS_V+wid*1024;
  #define DMA_K(t,slot) glds16(ksrc+(long)(t)*KVBLK*DM,(unsigned)__builtin_amdgcn_readfirstlane(kdst+(slot)))
  #define DMA_V(t,slot) glds16(vsrc+(long)(t)*KVBLK*DM,(unsigned)__builtin_amdgcn_readfirstlane(vdst+(slot)))
  const int vb0=(int)(lds0+LDS_V)+((lane>>4)&1)*32+(lane&3)*8+(4*hi+((lane&15)>>2))*64;
  const char*Kbase=shm+LDS_K; bf16x8 kf[8];
  const lds_cptr shm3=(lds_cptr)shm; const lds_cptr kp0=shm3+LDS_K+hi*1024+r32*16; const lds_cptr vp0=shm3+LDS_V+((lane>>4)&1)*32+(lane&3)*8+(4*hi+((lane&15)>>2))*64;
  const int NT=(q0+QB)/KVBLK;
  DMA_K(0,0);DMA_V(0,0);DMA_K(1,SLOTB);
  bf16x8 qr[4];
  #pragma unroll
  for(int d0=0;d0<4;++d0)qr[d0]=*reinterpret_cast<const bf16x8*>(&Qw[(long)r32*DM+d0*16+hi*8]);
  float mhat=0.f,l_reg=0.f;f32x16 o[2];o[0]=f32x16{};o[1]=f32x16{};
  const int qrel=wid*QBLK+r32;
  #define CMASK(P0,P1,t) do{int jb_=(t)-(NT-4); if(jb_>=0)cmask(P0,P1,jb_,qrel,hi);}while(0)
  bool resc=false;
  #define START(P0,P1) do{ const float rm=rowmax(P0,P1); resc=false; \
    { const float dl=rm; mhat=fadd_s(mhat,dl); \
      _Pragma("unroll") for(int r=0;r<16;++r){P0[r]=fsub_s(P0[r],dl);P1[r]=fsub_s(P1[r],dl);} } \
    _Pragma("unroll") for(int r=0;r<16;++r)P0[r]=__builtin_amdgcn_exp2f(P0[r]); }while(0)
  #define RESC() do{ if(resc){ asm volatile("s_waitcnt lgkmcnt(0)":::"memory"); \
      _Pragma("unroll") for(int d_=0;d_<2;++d_) _Pragma("unroll") for(int r=0;r<16;++r)o[d_][r]*=wsf[crow(r,hi)]; } }while(0)
  f32x16 pA0,pA1,pB0,pB1;
  #define BINIT(C0,C1,t) do{ const lds_f32*nb_=nbl+(t)*KVBLK+4*hi; \
    _Pragma("unroll") for(int g_=0;g_<4;++g_){ const f32x4_t a_=*(const __attribute__((address_space(3))) f32x4_t*)(nb_+8*g_); const f32x4_t b_=*(const __attribute__((address_space(3))) f32x4_t*)(nb_+32+8*g_); \
      _Pragma("unroll") for(int j_=0;j_<4;++j_){ C0[4*g_+j_]=a_[j_]-mhat; C1[4*g_+j_]=b_[j_]-mhat; } } }while(0)
  int sl_prev=0,sl_cur=0,sl_next=SLOTB;
  #define ROT() do{sl_prev=sl_cur;sl_cur=sl_next;sl_next=(sl_next==(NSLOT-1)*SLOTB)?0:sl_next+SLOTB;}while(0)
  DMA_K(2,2*SLOTB);
  WAIT_BAR(3);
  BINIT(pA0,pA1,0); qkt(pA0,pA1,Kbase,qr,r32,hi);asm volatile("s_nop 15\n\ts_nop 7":"+v"(pA0),"+v"(pA1));CMASK(pA0,pA1,0);
  START(pA0,pA1);
  _Pragma("unroll") for(int r=0;r<16;++r)pA1[r]=__builtin_amdgcn_exp2f(pA1[r]);
  WAIT_BAR(0);
  DMA_K(3,0);DMA_V(1,SLOTB);
  ROT();
  kload8(kf,kp0+sl_cur);
  WAIT_BAR(2);
  s16x4 vlo[8],vhi[8]; u32x4 pw0,pw1,pw2,pw3;
  #define PKW(P,B) cvtpk_s(P[B],P[B+1])
  #define PAF(k) __builtin_bit_cast(bf16x8,pw##k)
  #define VFR(i) (bf16x8){vlo[i][0],vlo[i][1],vlo[i][2],vlo[i][3],vhi[i][0],vhi[i][1],vhi[i][2],vhi[i][3]}
  #define PIN(x) asm volatile("":"+v"(x))
  #define MX3(a,b,c) __builtin_fmaxf(__builtin_fmaxf((a),(b)),(c))
  #define GAPA(MF,A0,A1,A2,A3,W0,W1,PW) do{ MF; sacc+=A0; sacc+=A1; sacc+=A2; sacc+=A3; PIN(sacc); W0; W1; PIN(PW); SBAR(); }while(0)
  #define EX(v) __builtin_amdgcn_exp2f(v)
  #define GAPB(MF,X,B) do{ MF; X[B]=EX(X[B]); X[B+1]=EX(X[B+1]); X[B+2]=EX(X[B+2]); X[B+3]=EX(X[B+3]); PIN(X); SBAR(); }while(0)
  #define VRD(i) do{ vlo[i]=vtr(vp_+(((i)>>2)*4096+((i)&3)*1024)); vhi[i]=vtr(vp_+(((i)>>2)*4096+((i)&3)*1024+512)); }while(0)
  #define KRD(G,j) do{ if(G){ kload2(kf,kp0+sl_next,j); SBAR(); } }while(0)
  #define STEP(C0,C1,P0,P1,t,GK,GV,GL) do{ SBAR(); BINIT(C0,C1,t); SBAR(); \
    const lds_cptr vp_=vp0+sl_prev; \
    VRD(0); SBAR(); float sacc=(P0[0]+P0[1]); \
    GAPA(C0=__builtin_amdgcn_mfma_f32_32x32x16_bf16(kf[0],qr[0],C0,0,0,0), P0[2],P0[3],P0[4],P0[5],     pw0[0]=PKW(P0,0), pw0[1]=PKW(P0,2), pw0); \
    VRD(4); SBAR(); GAPA(C1=__builtin_amdgcn_mfma_f32_32x32x16_bf16(kf[1],qr[0],C1,0,0,0), P0[6],P0[7],P0[8],P0[9],     pw0[2]=PKW(P0,4), pw0[3]=PKW(P0,6), pw0); \
    VRD(1); SBAR(); GAPA(C0=__builtin_amdgcn_mfma_f32_32x32x16_bf16(kf[2],qr[1],C0,0,0,0),   P0[10],P0[11],P0[12],P0[13], pw1[0]=PKW(P0,8), pw1[1]=PKW(P0,10), pw1); \
    VRD(5); SBAR(); GAPA(C1=__builtin_amdgcn_mfma_f32_32x32x16_bf16(kf[3],qr[1],C1,0,0,0),   P0[14],P0[15],P1[0],P1[1],   pw1[2]=PKW(P0,12),pw1[3]=PKW(P0,14), pw1); \
    VRD(2); SBAR(); GAPA(C0=__builtin_amdgcn_mfma_f32_32x32x16_bf16(kf[4],qr[2],C0,0,0,0),   P1[2],P1[3],P1[4],P1[5],     pw2[0]=PKW(P1,0), pw2[1]=PKW(P1,2), pw2); \
    VRD(6); SBAR(); GAPA(C1=__builtin_amdgcn_mfma_f32_32x32x16_bf16(kf[5],qr[2],C1,0,0,0),   P1[6],P1[7],P1[8],P1[9],     pw2[2]=PKW(P1,4), pw2[3]=PKW(P1,6), pw2); \
    VRD(3); SBAR(); GAPA(C0=__builtin_amdgcn_mfma_f32_32x32x16_bf16(kf[6],qr[3],C0,0,0,0),   P1[10],P1[11],P1[12],P1[13], pw3[0]=PKW(P1,8), pw3[1]=PKW(P1,10), pw3); \
    VRD(7); SBAR(); GAPA(C1=__builtin_amdgcn_mfma_f32_32x32x16_bf16(kf[7],qr[3],C1,0,0,0),   P1[14],P1[15],0.f,0.f,       pw3[2]=PKW(P1,12),pw3[3]=PKW(P1,14), pw3); \
    l_reg+=sacc; \
    if(GK){DMA_K((t)+3,sl_cur);} if(GV){DMA_V((t)+1,sl_next);} \
    CMASK(C0,C1,t); \
    { float a=MX3(C0[0],C0[1],C1[0]),b=MX3(C0[2],C0[3],C1[1]); a=MX3(a,C1[2],C1[3]); \
      _Pragma("unroll") for(int r=4;r<16;r+=4){a=MX3(a,C0[r],C0[r+1]);b=MX3(b,C0[r+2],C0[r+3]);a=MX3(a,C1[r],C1[r+1]);b=MX3(b,C1[r+2],C1[r+3]);} \
      float rm=__builtin_fmaxf(a,b); { auto rr=__builtin_amdgcn_permlane32_swap(__float_as_uint(rm),__float_as_uint(rm),false,false); rm=__builtin_fmaxf(__uint_as_float(rr[0]),__uint_as_float(rr[1])); } \
      resc=false; \
      if(__builtin_expect(__any(rm>(float)THRL),0)){ const float dl=__builtin_fmaxf(rm,0.f); mhat+=dl; \
        _Pragma("unroll") for(int r=0;r<16;++r){C0[r]-=dl;C1[r]-=dl;} \
        const float f=__builtin_amdgcn_exp2f(-dl); l_reg*=f; if(hi==0)wsf[r32]=f; resc=true; } } \
    SBAR(); \
    GAPB(o[0]=__builtin_amdgcn_mfma_f32_32x32x16_bf16(PAF(0),VFR(0),o[0],0,0,0), C0,0); \
    GAPB(o[1]=__builtin_amdgcn_mfma_f32_32x32x16_bf16(PAF(0),VFR(4),o[1],0,0,0), C0,4); \
    KRD(GL,0); GAPB(o[0]=__builtin_amdgcn_mfma_f32_32x32x16_bf16(PAF(1),VFR(1),o[0],0,0,0), C0,8); \
    KRD(GL,1); GAPB(o[1]=__builtin_amdgcn_mfma_f32_32x32x16_bf16(PAF(1),VFR(5),o[1],0,0,0), C0,12); \
    KRD(GL,2); GAPB(o[0]=__builtin_amdgcn_mfma_f32_32x32x16_bf16(PAF(2),VFR(2),o[0],0,0,0), C1,0); \
    KRD(GL,3); GAPB(o[1]=__builtin_amdgcn_mfma_f32_32x32x16_bf16(PAF(2),VFR(6),o[1],0,0,0), C1,4); \
    GAPB(o[0]=__builtin_amdgcn_mfma_f32_32x32x16_bf16(PAF(3),VFR(3),o[0],0,0,0), C1,8); \
    GAPB(o[1]=__builtin_amdgcn_mfma_f32_32x32x16_bf16(PAF(3),VFR(7),o[1],0,0,0), C1,12); \
    }while(0)
  int t=1;
  #undef CMASK
  #define CMASK(P0,P1,t) do{}while(0)
  for(;t+5<NT;t+=2){
    STEP(pB0,pB1,pA0,pA1,t,true,true,true);     WAIT_BAR(2); RESC(); ROT();
    STEP(pA0,pA1,pB0,pB1,t+1,true,true,true);   WAIT_BAR(2); RESC(); ROT();
  }
  #undef CMASK
  #define CMASK(P0,P1,t) do{int jb_=(t)-(NT-4); if(jb_>=0)cmask(P0,P1,jb_,qrel,hi);}while(0)
  #define ENDW(tt) do{ if((tt)+3<NT){WAIT_BAR(2);} else if((tt)+2<NT){WAIT_BAR(1);} else {WAIT_BAR(0);} }while(0)
  for(;t+1<NT;t+=2){
    STEP(pB0,pB1,pA0,pA1,t,(t+3<NT),(t+1<NT),(t+1<NT));       ENDW(t);   RESC(); ROT();
    STEP(pA0,pA1,pB0,pB1,t+1,(t+4<NT),(t+2<NT),(t+2<NT));     ENDW(t+1); RESC(); ROT();
  }
  STEP(pB0,pB1,pA0,pA1,NT-1,false,false,false); RESC();
  { float sacc=pB0[0]+pB0[1]; _Pragma("unroll") for(int r=2;r<16;++r)sacc+=pB0[r]; _Pragma("unroll") for(int r=0;r<16;++r)sacc+=pB1[r]; l_reg+=sacc;
    pw0=(u32x4){PKW(pB0,0),PKW(pB0,2),PKW(pB0,4),PKW(pB0,6)};pw1=(u32x4){PKW(pB0,8),PKW(pB0,10),PKW(pB0,12),PKW(pB0,14)};pw2=(u32x4){PKW(pB1,0),PKW(pB1,2),PKW(pB1,4),PKW(pB1,6)};pw3=(u32x4){PKW(pB1,8),PKW(pB1,10),PKW(pB1,12),PKW(pB1,14)};
    SBAR(); pv(o,vb0+sl_cur,PAF(0),PAF(1),PAF(2),PAF(3)); }
  #undef PKW
  #undef PAF
  #undef VFR
  #undef PIN
  #undef MX3
  #undef GAPA
  #undef GAPB
  #undef EX
  #undef VRD
  #undef KRD
  #undef STEP
  #undef ENDW
  {auto rr=__builtin_amdgcn_permlane32_swap(__float_as_uint(l_reg),__float_as_uint(l_reg),false,false);l_reg=__uint_as_float(rr[0])+__uint_as_float(rr[1]);}
  if(hi==0)wsf[32+r32]=l_reg;asm volatile("s_waitcnt lgkmcnt(0)":::"memory");
  float rli[16];
  #pragma unroll
  for(int r=0;r<16;++r)rli[r]=__builtin_amdgcn_rcpf(wsf[32+crow(r,hi)]);
  bf16*Ow=O+(rowbase+q0+wid*QBLK)*OPITCH+h*D; const bf16*Zw=Zg+(rowbase+q0+wid*QBLK)*DM+h*D;
  { bf16*stg=(bf16*)(shm+LDS_OST)+wid*2048;
    #pragma unroll
    for(int r=0;r<16;++r){const int orow=crow(r,hi);
      #pragma unroll
      for(int d0=0;d0<2;++d0)stg[orow*64+d0*32+r32]=__float2bfloat16(o[d0][r]*rli[r]);}
    asm volatile("s_waitcnt lgkmcnt(0)":::"memory");
    #pragma unroll
    for(int i=0;i<4;++i){const int row=i*8+(lane>>3),ch=lane&7; u32x4 v=*(const u32x4*)(stg+row*64+ch*8); const u32x4 z=*(const u32x4*)(Zw+(long)row*DM+ch*8);
      _Pragma("unroll") for(int e=0;e<4;++e){ const float z0=__uint_as_float(z[e]<<16),z1=__uint_as_float(z[e]&0xffff0000u),v0=__uint_as_float(v[e]<<16),v1=__uint_as_float(v[e]&0xffff0000u);
        v[e]=cvtpk_s(v0*z0/(1.f+__expf(-z0)),v1*z1/(1.f+__expf(-z1))); }
      ATTN_STORE16(Ow+(long)row*OPITCH+ch*8,v);} }
  asm volatile("s_waitcnt lgkmcnt(0)\n\ts_barrier":::"memory");
  #undef DMA_K
  #undef DMA_V
  #undef CMASK
  #undef BINIT
  #undef START
  #undef RESC
  #undef ROT
}
constexpr int ATTN_LDS_BYTES=LDS_BYTES;
#undef SBAR
#undef WAIT_BAR
}
#define LAS __attribute__((address_space(3)))
#define DI __device__ __forceinline__
typedef unsigned short bf16_t;
typedef float f32x4 __attribute__((ext_vector_type(4)));
typedef float f32x16 __attribute__((ext_vector_type(16)));
typedef short bf16x8 __attribute__((ext_vector_type(8)));
typedef short s16x4 __attribute__((ext_vector_type(4)));
typedef unsigned u32x4 __attribute__((ext_vector_type(4)));
typedef unsigned u32x2 __attribute__((ext_vector_type(2)));
constexpr int NWAVES = 8, NTHR = 512;
constexpr int BATCH = 4, SEQ = 4096, DMODEL = 1024, DEPTH = 4, M = BATCH * SEQ, NU = 4096;
constexpr float C2 = 0.125f * 1.4426950408889634f;
constexpr float ALPHA = 1.6817928305074292f;
constexpr float LN_EPS = 1e-5f;
constexpr int UC_FQ = 0, UC_FK = 384, UC_FV = 768, UC_FZ = 1152, UC_MQ = 1536, UC_MK = 1920, UC_MV = 2304, UC_MO = 2688, UC_MZ = 3072, UC_RQ = 3456, UC_RZ = 3712;
constexpr size_t MiB = 1u << 20;
constexpr size_t WS_CTL = 0, CTL_ZERO_BYTES = 65536, WS_G = 1 * MiB, WS_SM = 2 * MiB, WS_WKT = 4 * MiB, WS_WVT = 6 * MiB, WS_MB = 8 * MiB, WS_MK = 10 * MiB, WS_MVT = 12 * MiB,
                 WS_WOUT = 16 * MiB, WS_WIN = 24 * MiB, WS_XB = 56 * MiB, WS_MIX = 56 * MiB, WS_U = 88 * MiB, WS_Y = 88 * MiB, WS_UC = 216 * MiB, WS_CP = 234 * MiB, WS_END = 252 * MiB;
constexpr size_t SM_A = 0, SM_BL = 4096, SM_MP = 8192, SM_NV = 16384, SM_NP = 16384 + 393216;
constexpr int CW_Q = 0, CW_ARR = 1024;
constexpr int LDS_BYTES = 147456, LDS_CTL = 131072;

DI float bf2f(unsigned v) { return __uint_as_float(v << 16); }
DI unsigned f2bf(float f) { unsigned u = __float_as_uint(f); return (u + 0x7fffu + ((u >> 16) & 1u)) >> 16; }
DI unsigned pk2(float lo, float hi) { return f2bf(lo) | (f2bf(hi) << 16); }
DI float logsig(float x) { return fminf(x, 0.f) - log1pf(__expf(-fabsf(x))); }
DI float siluf(float x) { return x / (1.f + __expf(-x)); }
DI float sigmf(float x) { return 1.f / (1.f + __expf(-x)); }
DI int crow(int r, int hi) { return (r & 3) + 8 * (r >> 2) + 4 * hi; }
DI float wave_sum(float v) {
#pragma unroll
    for (int o = 1; o < 64; o <<= 1) v += __shfl_xor(v, o);
    return v;
}
DI float wave_max(float v) {
#pragma unroll
    for (int o = 1; o < 64; o <<= 1) v = fmaxf(v, __shfl_xor(v, o));
    return v;
}
#define LDS_WAIT() asm volatile("s_waitcnt lgkmcnt(0)" ::: "memory")
#define VM_WAIT() asm volatile("s_waitcnt vmcnt(0)" ::: "memory")

struct Args { const float* in[13]; float* out; unsigned char* ws; };
struct Ctx {
    LAS unsigned char* lds; int G, bid;
    const float *x, *mem, *w_in, *fox_fb, *conv_w, *conv_b, *i_bias, *f_bias, *norm_g, *w_mkv, *w_out, *ln_g, *ln_b;
    float* out; unsigned char* ws;
    DI bf16_t* WinT() const { return (bf16_t*)(ws + WS_WIN); }
    DI bf16_t* WoutT() const { return (bf16_t*)(ws + WS_WOUT); }
    DI bf16_t* WkT() const { return (bf16_t*)(ws + WS_WKT); }
    DI bf16_t* WvT() const { return (bf16_t*)(ws + WS_WVT); }
    DI bf16_t* MB() const { return (bf16_t*)(ws + WS_MB); }
    DI bf16_t* MK() const { return (bf16_t*)(ws + WS_MK); }
    DI bf16_t* MVT() const { return (bf16_t*)(ws + WS_MVT); }
    DI bf16_t* XB() const { return (bf16_t*)(ws + WS_XB); }
    DI bf16_t* MIX() const { return (bf16_t*)(ws + WS_MIX); }
    DI bf16_t* U() const { return (bf16_t*)(ws + WS_U); }
    DI bf16_t* UCb() const { return (bf16_t*)(ws + WS_UC); }
    DI bf16_t* CPb() const { return (bf16_t*)(ws + WS_CP); }
    DI float* Gt() const { return (float*)(ws + WS_G); }
    DI float* Y() const { return (float*)(ws + WS_Y); }
    DI float* Aarr() const { return (float*)(ws + WS_SM + SM_A); }
    DI float* BL() const { return (float*)(ws + WS_SM + SM_BL); }
    DI float* MP() const { return (float*)(ws + WS_SM + SM_MP); }
    DI float* NV() const { return (float*)(ws + WS_SM + SM_NV); }
    DI float* NP() const { return (float*)(ws + WS_SM + SM_NP); }
    DI unsigned* ctl() const { return (unsigned*)(ws + WS_CTL); }
};

DI int win_src(int n, float& sc) {
    sc = 1.f;
    if (n < 1152) { if (n < 384) sc = C2; return n; }
    if (n < 2688) return n + 6;
    if (n < 3968) { if (n >= UC_RQ && n < UC_RZ) sc = C2; return n + 14; }
    if (n < 3974) return 1152 + (n - 3968);
    if (n < 3978) return 2694 + (n - 3974);
    if (n < 3982) return 2698 + (n - 3978);
    return -1;
}
template <int MODE> DI void p0_item(const float* W, int Nsrc, int coloff, bf16_t* WT, int K, int item, int nblk, LAS float* scr, int lane) {
    const int kb = item / nblk, nb = item % nblk, k0 = 64 * kb, n0 = 32 * nb;
    const int n = n0 + (lane & 31); float sc = 1.f; int src = n + coloff; if (MODE == 1) src = win_src(n, sc);
#pragma unroll 8
    for (int i = 0; i < 32; ++i) { const int kk = 2 * i + (lane >> 5); scr[kk * 33 + (lane & 31)] = (src >= 0) ? W[(size_t)(k0 + kk) * Nsrc + src] * sc : 0.f; }
    LDS_WAIT(); asm volatile("" ::: "memory");
    const int c = lane & 7;
#pragma unroll
    for (int j = 0; j < 4; ++j) { const int nn = (lane >> 3) + 8 * j; const LAS float* s = scr + (8 * c) * 33 + nn;
        u32x4 o; o.x = pk2(s[0 * 33], s[1 * 33]); o.y = pk2(s[2 * 33], s[3 * 33]); o.z = pk2(s[4 * 33], s[5 * 33]); o.w = pk2(s[6 * 33], s[7 * 33]);
        *(u32x4*)(WT + (size_t)(n0 + nn) * K + k0 + 8 * c) = o; }
    LDS_WAIT(); asm volatile("" ::: "memory");
}
DI void cvt_rows(const float* src, bf16_t* dst, size_t n8, size_t gt, size_t ngt) {
    for (size_t i = gt; i < n8; i += ngt) { const f32x4 a = *(const f32x4*)(src + i * 8), b = *(const f32x4*)(src + i * 8 + 4);
        u32x4 o; o.x = pk2(a[0], a[1]); o.y = pk2(a[2], a[3]); o.z = pk2(b[0], b[1]); o.w = pk2(b[2], b[3]); *(u32x4*)(dst + i * 8) = o; }
}
DI void p0_prologue(const Ctx& F) {
    const int tid = fresh_tid(), lane = tid & 63, wave = __builtin_amdgcn_readfirstlane(tid >> 6);
    LAS float* scr = (LAS float*)(F.lds + wave * 16384);
    const int gw = F.bid * NWAVES + wave, NGW = F.G * NWAVES;
    constexpr int I_IN = 16 * 128, I_OUT = 16 * 32, I_KV = 16 * 8;
    constexpr int NITEMS = DEPTH * (I_IN + I_OUT + 2 * I_KV);
    for (int it = gw; it < NITEMS; it += NGW) {
        int r = it;
        if (r < DEPTH * I_IN) { const int l = r / I_IN; p0_item<1>(F.w_in + (size_t)l * 1024 * 3982, 3982, 0, F.WinT() + (size_t)l * 4096 * 1024, 1024, r % I_IN, 128, scr, lane); continue; } r -= DEPTH * I_IN;
        if (r < DEPTH * I_OUT) { const int l = r / I_OUT; p0_item<0>(F.w_out + (size_t)l * 1024 * 1024, 1024, 0, F.WoutT() + (size_t)l * 1024 * 1024, 1024, r % I_OUT, 32, scr, lane); continue; } r -= DEPTH * I_OUT;
        if (r < DEPTH * I_KV) { const int l = r / I_KV; p0_item<0>(F.w_mkv + (size_t)l * 1024 * 512, 512, 0, F.WkT() + (size_t)l * 256 * 1024, 1024, r % I_KV, 8, scr, lane); continue; } r -= DEPTH * I_KV;
        { const int l = r / I_KV; p0_item<0>(F.w_mkv + (size_t)l * 1024 * 512, 512, 256, F.WvT() + (size_t)l * 256 * 1024, 1024, r % I_KV, 8, scr, lane); }
    }
    const size_t gt = (size_t)F.bid * NTHR + tid, ngt = (size_t)F.G * NTHR;
    cvt_rows(F.x, F.XB(), (size_t)M * DMODEL / 8, gt, ngt);
    cvt_rows(F.mem, F.MB(), (size_t)1024 * 1024 / 8, gt, ngt);
}

DI void ln_phase(const Ctx& F, const float* xin, const float* lg, const float* lb) {
    const int tid = fresh_tid(), lane = tid & 63, wave = __builtin_amdgcn_readfirstlane(tid >> 6); (void)tid;
    const int gw = F.bid * NWAVES + wave, NGW = F.G * NWAVES;
    for (int m = gw; m < M; m += NGW) {
        const f32x4* xr = (const f32x4*)(xin + (size_t)m * DMODEL) + lane; const f32x4* yr = (const f32x4*)(F.Y() + (size_t)m * DMODEL) + lane;
        f32x4 v[4]; float s = 0.f;
#pragma unroll
        for (int j = 0; j < 4; ++j) { v[j] = xr[64 * j] * ALPHA + yr[64 * j]; s += (v[j][0] + v[j][1]) + (v[j][2] + v[j][3]); }
        const float mean = wave_sum(s) * (1.f / DMODEL); float s2 = 0.f;
#pragma unroll
        for (int j = 0; j < 4; ++j) { v[j] = v[j] - mean; s2 += (v[j][0] * v[j][0] + v[j][1] * v[j][1]) + (v[j][2] * v[j][2] + v[j][3] * v[j][3]); }
        const float rstd = 1.f / sqrtf(wave_sum(s2) * (1.f / DMODEL) + LN_EPS);
        f32x4* orow = (f32x4*)(F.out + (size_t)m * DMODEL) + lane; u32x2* brow = (u32x2*)(F.XB() + (size_t)m * DMODEL) + lane;
#pragma unroll
        for (int j = 0; j < 4; ++j) { const f32x4 g = *((const f32x4*)lg + lane + 64 * j), bb = *((const f32x4*)lb + lane + 64 * j);
            const f32x4 o = v[j] * rstd * g + bb; orow[64 * j] = o; u32x2 w; w.x = pk2(o[0], o[1]); w.y = pk2(o[2], o[3]); brow[64 * j] = w; }
    }
}
constexpr int ML_KT = 0, ML_VT = 13824, ML_Q = 27648, ML_K = 40960, ML_CP = 54272, ML_F = 74240, ML_H = 77824;
constexpr int MLF_WV = 0, MLF_BB = 64, MLF_GG = 128, MLF_MROW = 192, MLF_DEC = 256, MLF_RS = 320, MLF_QN = 384, MLF_NP = 448, MLF_FLAG = 560;
DI void conv8(const bf16_t* Ucol, size_t row, int tloc, const float* cw, const float* cb, int ch, float scale, float (&o)[8]) {
    const f32x4 b0 = *(const f32x4*)(cb + ch), b1 = *(const f32x4*)(cb + ch + 4);
    float acc[8] = {b0[0], b0[1], b0[2], b0[3], b1[0], b1[1], b1[2], b1[3]};
#pragma unroll
    for (int j = 0; j < 4; ++j) {
        if (tloc - 3 + j >= 0) {
            const u32x4 v = *(const u32x4*)(Ucol + (row - 3 + j) * NU);
            const f32x4 w0 = *(const f32x4*)(cw + j * 768 + ch), w1 = *(const f32x4*)(cw + j * 768 + ch + 4);
            acc[0] += w0[0] * bf2f(v[0] & 0xffffu); acc[1] += w0[1] * __uint_as_float(v[0] & 0xffff0000u);
            acc[2] += w0[2] * bf2f(v[1] & 0xffffu); acc[3] += w0[3] * __uint_as_float(v[1] & 0xffff0000u);
            acc[4] += w1[0] * bf2f(v[2] & 0xffffu); acc[5] += w1[1] * __uint_as_float(v[2] & 0xffff0000u);
            acc[6] += w1[2] * bf2f(v[3] & 0xffffu); acc[7] += w1[3] * __uint_as_float(v[3] & 0xffff0000u);
        }
    }
#pragma unroll
    for (int i = 0; i < 8; ++i) o[i] = siluf(acc[i]) * scale;
}
DI float ld_f32_agent(const float* p) { return __uint_as_float(__hip_atomic_load((const unsigned*)p, __ATOMIC_RELAXED, __HIP_MEMORY_SCOPE_AGENT)); }

DI void ml_scan(const Ctx& F, int bh) {
    const int tid = fresh_tid();
    float st[19];
#pragma unroll
    for (int j = 0; j < 19; ++j) st[j] = 0.f;
    float m = 0.f;
    for (int c = 0; c < 64; ++c) {
        const size_t base = (size_t)bh * 64 + c;
#pragma unroll
        for (int j = 0; j < 19; ++j) { const int idx = tid + 512 * j;
            if (j < 18) F.CPb()[base * 9216 + idx] = (bf16_t)f2bf(st[j]); else if (idx < 9312) F.NP()[base * 96 + idx - 9216] = st[j]; }
        if (tid == 0) F.MP()[base] = m;
        const float a = ld_f32_agent(F.Aarr() + base), bl = ld_f32_agent(F.BL() + base);
        const float mn = fmaxf(bl + m, a), cd = __expf(bl + m - mn), sc = __expf(a - mn);
#pragma unroll
        for (int j = 0; j < 19; ++j) { const int idx = tid + 512 * j;
            float u = 0.f; if (j < 18) u = bf2f(F.UCb()[base * 9216 + idx]); else if (idx < 9312) u = F.NV()[base * 96 + idx - 9216];
            st[j] = cd * st[j] + sc * u; }
        m = mn;
    }
}
DI void ml_item1(const Ctx& F, int l, int bh, int c) {
    const int tid = fresh_tid(), lane = tid & 63, wid = __builtin_amdgcn_readfirstlane(tid >> 6), b = bh >> 2, h = bh & 3, r = lane & 31, hh = lane >> 5;
    const size_t row0 = (size_t)b * SEQ + (size_t)c * 64;
    LAS float* fl = (LAS float*)(F.lds + ML_F);
    LAS bf16_t* kt = (LAS bf16_t*)(F.lds + ML_KT); LAS bf16_t* vt = (LAS bf16_t*)(F.lds + ML_VT);
    const size_t base = (size_t)bh * 64 + c;
    if (wid == 0) {
        const float* g = F.Gt() + (row0 + lane) * 16;
        const float li = g[6 + h] + F.i_bias[l * 4 + h], lf = logsig(g[10 + h] + F.f_bias[l * 4 + h]);
        float bc = lf;
#pragma unroll
        for (int o = 1; o < 64; o <<= 1) { const float v = __shfl_up(bc, o); if (lane >= o) bc += v; }
        const float blast = __shfl(bc, 63), lw = blast - bc + li, a = wave_max(lw);
        fl[MLF_WV + lane] = __expf(lw - a);
        if (lane == 0) { F.Aarr()[base] = a; F.BL()[base] = blast; }
    }
    __syncthreads();
    const float* cw = F.conv_w + (size_t)l * 4 * 768; const float* cb = F.conv_b + (size_t)l * 768;
    for (int task = tid; task < 768; task += NTHR) {
        const int s = task / 12, g8 = task % 12; float kc[8];
        conv8(F.U() + UC_MK + h * 96 + g8 * 8, row0 + s, c * 64 + s, cw, cb, 384 + h * 96 + g8 * 8, 0.10206207261596575f, kc);
#pragma unroll
        for (int i = 0; i < 8; ++i) kt[(g8 * 8 + i) * 72 + s] = (bf16_t)f2bf(kc[i]);
        const u32x4 v = *(const u32x4*)(F.U() + (row0 + s) * NU + UC_MV + h * 96 + g8 * 8); const float w = fl[MLF_WV + s];
#pragma unroll
        for (int i = 0; i < 4; ++i) { vt[(g8 * 8 + 2 * i) * 72 + s] = (bf16_t)f2bf(w * bf2f(v[i] & 0xffffu)); vt[(g8 * 8 + 2 * i + 1) * 72 + s] = (bf16_t)f2bf(w * __uint_as_float(v[i] & 0xffff0000u)); }
    }
    __syncthreads();
    for (int tile = wid; tile < 9; tile += 8) {
        const int te = tile / 3, td = tile % 3; f32x16 acc;
#pragma unroll
        for (int i = 0; i < 16; ++i) acc[i] = 0.f;
#pragma unroll
        for (int ks = 0; ks < 4; ++ks) {
            const bf16x8 a = *(const LAS bf16x8*)(vt + (32 * te + r) * 72 + 16 * ks + 8 * hh), bb = *(const LAS bf16x8*)(kt + (32 * td + r) * 72 + 16 * ks + 8 * hh);
            acc = __builtin_amdgcn_mfma_f32_32x32x16_bf16(a, bb, acc, 0, 0, 0);
        }
#pragma unroll
        for (int i = 0; i < 16; ++i) F.UCb()[base * 9216 + (size_t)(32 * te + crow(i, hh)) * 96 + 32 * td + r] = (bf16_t)f2bf(acc[i]);
    }
    if (tid < 96) { float s = 0.f;
#pragma unroll 8
        for (int j = 0; j < 64; ++j) s += fl[MLF_WV + j] * bf2f(kt[tid * 72 + j]);
        F.NV()[base * 96 + tid] = s; }
    VM_WAIT(); __syncthreads();
    if (tid == 0) {
        __threadfence();
        const unsigned old = __hip_atomic_fetch_add(F.ctl() + CW_ARR + 64 * (16 * l + bh), 1u, __ATOMIC_RELAXED, __HIP_MEMORY_SCOPE_AGENT);
        const unsigned last = (old == 63u) ? 1u : 0u;
        if (last) __threadfence();
        ((LAS unsigned*)fl)[MLF_FLAG] = last;
    }
    __syncthreads();
    const unsigned last = ((LAS unsigned*)fl)[MLF_FLAG];
    if (last) ml_scan(F, bh);
    __syncthreads();
}
DI void ml_item3(const Ctx& F, int l, int bh, int c) {
    const int tid = fresh_tid(), lane = tid & 63, wid = __builtin_amdgcn_readfirstlane(tid >> 6), b = bh >> 2, h = bh & 3, r = lane & 31, hh = lane >> 5;
    const size_t row0 = (size_t)b * SEQ + (size_t)c * 64; const size_t base = (size_t)bh * 64 + c;
    LAS float* fl = (LAS float*)(F.lds + ML_F);
    LAS bf16_t* vt = (LAS bf16_t*)(F.lds + ML_VT); LAS bf16_t* qs = (LAS bf16_t*)(F.lds + ML_Q); LAS bf16_t* ks_ = (LAS bf16_t*)(F.lds + ML_K); LAS bf16_t* cp = (LAS bf16_t*)(F.lds + ML_CP);
    LAS float* hhs = (LAS float*)(F.lds + ML_H);
    if (wid == 0) {
        const float* g = F.Gt() + (row0 + lane) * 16;
        const float li = g[6 + h] + F.i_bias[l * 4 + h], lf = logsig(g[10 + h] + F.f_bias[l * 4 + h]);
        float bc = lf;
#pragma unroll
        for (int o = 1; o < 64; o <<= 1) { const float v = __shfl_up(bc, o); if (lane >= o) bc += v; }
        const float gg = li - bc; float pm = gg;
#pragma unroll
        for (int o = 1; o < 64; o <<= 1) { const float v = __shfl_up(pm, o); if (lane >= o) pm = fmaxf(pm, v); }
        const float mp = F.MP()[base], mrow = fmaxf(bc + mp, bc + pm);
        fl[MLF_BB + lane] = bc; fl[MLF_GG + lane] = gg; fl[MLF_MROW + lane] = mrow; fl[MLF_DEC + lane] = __expf(bc + mp - mrow); fl[MLF_RS + lane] = 0.f;
    }
    if (wid == 1) { fl[MLF_NP + lane] = F.NP()[base * 96 + lane]; if (lane < 32) fl[MLF_NP + 64 + lane] = F.NP()[base * 96 + 64 + lane]; }
    const float* cw = F.conv_w + (size_t)l * 4 * 768; const float* cb = F.conv_b + (size_t)l * 768;
    for (int task = tid; task < 768; task += NTHR) {
        const int s = task / 12, g8 = task % 12; float t8[8]; u32x4 w;
        conv8(F.U() + UC_MQ + h * 96 + g8 * 8, row0 + s, c * 64 + s, cw, cb, h * 96 + g8 * 8, 1.f, t8);
        w.x = pk2(t8[0], t8[1]); w.y = pk2(t8[2], t8[3]); w.z = pk2(t8[4], t8[5]); w.w = pk2(t8[6], t8[7]); *(LAS u32x4*)(qs + s * 104 + g8 * 8) = w;
        conv8(F.U() + UC_MK + h * 96 + g8 * 8, row0 + s, c * 64 + s, cw, cb, 384 + h * 96 + g8 * 8, 0.10206207261596575f, t8);
        w.x = pk2(t8[0], t8[1]); w.y = pk2(t8[2], t8[3]); w.z = pk2(t8[4], t8[5]); w.w = pk2(t8[6], t8[7]); *(LAS u32x4*)(ks_ + s * 104 + g8 * 8) = w;
        const u32x4 v = *(const u32x4*)(F.U() + (row0 + s) * NU + UC_MV + h * 96 + g8 * 8);
#pragma unroll
        for (int i = 0; i < 4; ++i) { vt[(g8 * 8 + 2 * i) * 72 + s] = (bf16_t)(v[i] & 0xffffu); vt[(g8 * 8 + 2 * i + 1) * 72 + s] = (bf16_t)(v[i] >> 16); }
    }
    for (int task = tid; task < 1152; task += NTHR) { const int e = task / 12, p = task % 12; *(LAS u32x4*)(cp + e * 104 + p * 8) = *(const u32x4*)(F.CPb() + base * 9216 + e * 96 + p * 8); }
    __syncthreads();
    const int tt = wid / 3, te = wid % 3;
    f32x16 sv, qc;
#pragma unroll
    for (int i = 0; i < 16; ++i) { sv[i] = 0.f; qc[i] = 0.f; }
    if (wid < 6) {
#pragma unroll
        for (int kk = 0; kk < 6; ++kk) {
            const bf16x8 a = *(const LAS bf16x8*)(qs + (32 * tt + r) * 104 + 16 * kk + 8 * hh), bb = *(const LAS bf16x8*)(cp + (32 * te + r) * 104 + 16 * kk + 8 * hh);
            qc = __builtin_amdgcn_mfma_f32_32x32x16_bf16(a, bb, qc, 0, 0, 0);
        }
        const int t = 32 * tt + r; const float bt = fl[MLF_BB + t], mr = fl[MLF_MROW + t]; float rsum = 0.f;
        for (int ts = 0; ts <= tt; ++ts) {
            f32x16 x;
#pragma unroll
            for (int i = 0; i < 16; ++i) x[i] = 0.f;
#pragma unroll
            for (int kk = 0; kk < 6; ++kk) {
                const bf16x8 a = *(const LAS bf16x8*)(ks_ + (32 * ts + r) * 104 + 16 * kk + 8 * hh), bb = *(const LAS bf16x8*)(qs + (32 * tt + r) * 104 + 16 * kk + 8 * hh);
                x = __builtin_amdgcn_mfma_f32_32x32x16_bf16(a, bb, x, 0, 0, 0);
            }
#pragma unroll
            for (int i = 0; i < 16; ++i) { const int s = 32 * ts + crow(i, hh); const float e = __expf(fminf(bt + fl[MLF_GG + s] - mr, 0.f)); const float v = (s <= t) ? x[i] * e : 0.f; x[i] = v; rsum += v; }
#pragma unroll
            for (int sp = 0; sp < 2; ++sp) {
                u32x4 pw; pw.x = pk2(x[8 * sp + 0], x[8 * sp + 1]); pw.y = pk2(x[8 * sp + 2], x[8 * sp + 3]); pw.z = pk2(x[8 * sp + 4], x[8 * sp + 5]); pw.w = pk2(x[8 * sp + 6], x[8 * sp + 7]);
                const int s0 = 32 * ts + 16 * sp + 4 * hh;
                const s16x4 lo = *(const LAS s16x4*)(vt + (32 * te + r) * 72 + s0), hi = *(const LAS s16x4*)(vt + (32 * te + r) * 72 + s0 + 8);
                const bf16x8 vb = (bf16x8){lo[0], lo[1], lo[2], lo[3], hi[0], hi[1], hi[2], hi[3]};
                sv = __builtin_amdgcn_mfma_f32_32x32x16_bf16(__builtin_bit_cast(bf16x8, pw), vb, sv, 0, 0, 0);
            }
        }
        if (te == 0) atomicAdd((float*)(fl + MLF_RS + t), rsum);
    } else if (wid == 6) {
        float s = 0.f;
#pragma unroll 8
        for (int d = 0; d < 96; ++d) s += bf2f(qs[lane * 104 + d]) * fl[MLF_NP + d];
        fl[MLF_QN + lane] = s;
    }
    __syncthreads();
    if (wid < 6) {
        const bf16_t* mo = F.U() + UC_MO + h * 96 + 32 * te + r;
#pragma unroll
        for (int i = 0; i < 16; ++i) { const int t = 32 * tt + crow(i, hh); const float dec = fl[MLF_DEC + t], den = fl[MLF_RS + t] + dec * fl[MLF_QN + t];
            const float hd = 1.f / fmaxf(fabsf(den), __expf(-fl[MLF_MROW + t])); const float num = sv[i] + dec * qc[i];
            const float og = sigmf(bf2f(mo[(row0 + t) * NU]));
            hhs[t * 97 + 32 * te + r] = og * num * hd; }
    }
    __syncthreads();
    {
        const int t = tid >> 3, p = tid & 7; float v[12]; float s = 0.f;
#pragma unroll
        for (int i = 0; i < 12; ++i) { v[i] = hhs[t * 97 + p * 12 + i]; s += v[i]; }
        s += __shfl_xor(s, 1); s += __shfl_xor(s, 2); s += __shfl_xor(s, 4);
        const float mu = s * (1.f / 96.f); float q = 0.f;
#pragma unroll
        for (int i = 0; i < 12; ++i) { v[i] -= mu; q += v[i] * v[i]; }
        q += __shfl_xor(q, 1); q += __shfl_xor(q, 2); q += __shfl_xor(q, 4);
        const float rstd = 1.f / sqrtf(q * (1.f / 96.f) + LN_EPS);
        const bf16_t* mz = F.U() + (row0 + t) * NU + UC_MZ + h * 96 + p * 12; const float* ng = F.norm_g + l * 384 + h * 96 + p * 12;
        bf16_t* op = F.MIX() + (row0 + t) * DMODEL + 384 + h * 96 + p * 12;
#pragma unroll
        for (int i = 0; i < 12; i += 4) { const u32x2 z = *(const u32x2*)(mz + i);
            const float o0 = v[i] * rstd * ng[i] * siluf(bf2f(z[0] & 0xffffu)), o1 = v[i + 1] * rstd * ng[i + 1] * siluf(__uint_as_float(z[0] & 0xffff0000u));
            const float o2 = v[i + 2] * rstd * ng[i + 2] * siluf(bf2f(z[1] & 0xffffu)), o3 = v[i + 3] * rstd * ng[i + 3] * siluf(__uint_as_float(z[1] & 0xffff0000u));
            u32x2 w; w.x = pk2(o0, o1); w.y = pk2(o2, o3); *(u32x2*)(op + i) = w; }
    }
    __syncthreads();
}
constexpr int MA_K = 0, MA_VT = 36864, MA_L = 70656;
DI void mem_item(const Ctx& F, int l, int b, int hm, int rb) {
    const int tid = fresh_tid(), lane = tid & 63, wid = __builtin_amdgcn_readfirstlane(tid >> 6), r = lane & 31, hh = lane >> 5;
    LAS bf16_t* Ks = (LAS bf16_t*)(F.lds + MA_K); LAS bf16_t* Vts = (LAS bf16_t*)(F.lds + MA_VT); LAS float* lw = (LAS float*)(F.lds + MA_L) + wid * 32;
    for (int p = tid; p < 2048; p += NTHR) { const int m = p >> 3, c8 = p & 7;
        *(LAS u32x4*)(Ks + m * 72 + c8 * 8) = *(const u32x4*)(F.MK() + (size_t)(b * 256 + m) * 1024 + l * 256 + hm * 64 + c8 * 8); }
    for (int p = tid; p < 2048; p += NTHR) { const int d = p >> 5, c8 = p & 31;
        *(LAS u32x4*)(Vts + d * 264 + c8 * 8) = *(const u32x4*)(F.MVT() + (size_t)(l * 256 + hm * 64 + d) * 1024 + b * 256 + c8 * 8); }
    const size_t rowq = (size_t)b * SEQ + (size_t)rb * 256 + wid * 32;
    bf16x8 qf[4];
#pragma unroll
    for (int kk = 0; kk < 4; ++kk) qf[kk] = *(const bf16x8*)(F.U() + (rowq + r) * NU + UC_RQ + hm * 64 + 16 * kk + 8 * hh);
    __syncthreads();
    f32x16 x[8];
#pragma unroll
    for (int kt = 0; kt < 8; ++kt) {
#pragma unroll
        for (int i = 0; i < 16; ++i) x[kt][i] = 0.f;
#pragma unroll
        for (int kk = 0; kk < 4; ++kk) { const bf16x8 a = *(const LAS bf16x8*)(Ks + (32 * kt + r) * 72 + 16 * kk + 8 * hh);
            x[kt] = __builtin_amdgcn_mfma_f32_32x32x16_bf16(a, qf[kk], x[kt], 0, 0, 0); }
    }
    float mx = -INFINITY;
#pragma unroll
    for (int kt = 0; kt < 8; ++kt)
#pragma unroll
        for (int i = 0; i < 16; ++i) mx = fmaxf(mx, x[kt][i]);
    mx = fmaxf(mx, __shfl_xor(mx, 32));
    float ls = 0.f;
    f32x16 o[2];
#pragma unroll
    for (int i = 0; i < 16; ++i) { o[0][i] = 0.f; o[1][i] = 0.f; }
#pragma unroll
    for (int kt = 0; kt < 8; ++kt) {
#pragma unroll
        for (int i = 0; i < 16; ++i) { const float p = __builtin_amdgcn_exp2f(x[kt][i] - mx); x[kt][i] = p; ls += p; }
#pragma unroll
        for (int sp = 0; sp < 2; ++sp) {
            u32x4 pw; pw.x = pk2(x[kt][8 * sp + 0], x[kt][8 * sp + 1]); pw.y = pk2(x[kt][8 * sp + 2], x[kt][8 * sp + 3]); pw.z = pk2(x[kt][8 * sp + 4], x[kt][8 * sp + 5]); pw.w = pk2(x[kt][8 * sp + 6], x[kt][8 * sp + 7]);
            const int s0 = 32 * kt + 16 * sp + 4 * hh;
#pragma unroll
            for (int dt = 0; dt < 2; ++dt) {
                const s16x4 lo = *(const LAS s16x4*)(Vts + (32 * dt + r) * 264 + s0), hi = *(const LAS s16x4*)(Vts + (32 * dt + r) * 264 + s0 + 8);
                const bf16x8 vb = (bf16x8){lo[0], lo[1], lo[2], lo[3], hi[0], hi[1], hi[2], hi[3]};
                o[dt] = __builtin_amdgcn_mfma_f32_32x32x16_bf16(__builtin_bit_cast(bf16x8, pw), vb, o[dt], 0, 0, 0);
            }
        }
    }
    ls += __shfl_xor(ls, 32);
    if (hh == 0) lw[r] = ls;
    LDS_WAIT(); asm volatile("" ::: "memory");
    const bf16_t* rz = F.U() + rowq * NU + UC_RZ + hm * 64; bf16_t* op = F.MIX() + rowq * DMODEL + 768 + hm * 64;
#pragma unroll
    for (int i = 0; i < 16; ++i) { const int q = crow(i, hh); const float rl = 1.f / lw[q];
#pragma unroll
        for (int dt = 0; dt < 2; ++dt) { const float z = bf2f(rz[(size_t)q * NU + 32 * dt + r]); op[(size_t)q * DMODEL + 32 * dt + r] = (bf16_t)f2bf(o[dt][i] * rl * siluf(z)); } }
    __syncthreads();
}

__global__ void __launch_bounds__(NTHR, 2) hybrid_fwd(Args args) {
    extern __shared__ __attribute__((aligned(16))) unsigned char lds[];
    cg::grid_group grid = cg::this_grid();
    Ctx F;
    F.lds = (LAS unsigned char*)lds; F.G = gridDim.x; F.bid = blockIdx.x;
    F.x = args.in[0]; F.mem = args.in[1]; F.w_in = args.in[2]; F.fox_fb = args.in[3]; F.conv_w = args.in[4]; F.conv_b = args.in[5]; F.i_bias = args.in[6]; F.f_bias = args.in[7];
    F.norm_g = args.in[8]; F.w_mkv = args.in[9]; F.w_out = args.in[10]; F.ln_g = args.in[11]; F.ln_b = args.in[12];
    F.out = args.out; F.ws = args.ws;
    LAS unsigned* ldsctl = (LAS unsigned*)(F.lds + LDS_CTL);

    p0_prologue(F);
    grid.sync();
    { pg8::Gemm g{F.MB(), F.WkT(), 1024, 1024, 1024}; pg8::StaticOrder S; S.init(1024, 1024, F.G, F.bid); pg8::EpiBf16<0> E{F.MK(), 1024, nullptr, 0, 0, 1.f};
      pg8::gemm_phase<pg8::EpiBf16<0>, pg8::StaticOrder, false, true>(F.lds, g, S, E); }
    { pg8::Gemm g{F.WvT(), F.MB(), 1024, 1024, 1024}; pg8::StaticOrder S; S.init(1024, 1024, F.G, (F.bid + 128) % F.G); pg8::EpiBf16<0> E{F.MVT(), 1024, nullptr, 0, 0, 1.f};
      pg8::gemm_phase<pg8::EpiBf16<0>, pg8::StaticOrder, false, true>(F.lds, g, S, E); }
    __syncthreads();

    for (int l = 0; l < DEPTH; ++l) {
        { pg8::Gemm g{F.XB(), F.WinT() + (size_t)l * 4096 * 1024, M, NU, 1024}; pg8::StaticOrder S; S.init(M, NU, F.G, F.bid); pg8::EpiU E{F.U(), F.Gt()};
          pg8::gemm_phase<pg8::EpiU, pg8::StaticOrder, true, true>(F.lds, g, S, E); }
        grid.sync();
        for (;;) {
            if (threadIdx.x == 0) ldsctl[0] = __hip_atomic_fetch_add(F.ctl() + CW_Q + 64 * l, 1u, __ATOMIC_RELAXED, __HIP_MEMORY_SCOPE_AGENT);
            __syncthreads();
            const int it = (int)ldsctl[0];
            __syncthreads();
            if (it >= 1664) break;
#ifndef NO_ML1
            if (it < 1024) ml_item1(F, l, it & 15, it >> 4);
            else
#endif
#ifndef NO_ATTN
            if (it < 1408) { const int j = it - 1024, qb = 15 - j / 24, bhf = j % 24, b = bhf / 6, h = bhf % 6;
                attn_body::attn_unit<8>(b, h, qb, (const attn_body::bf16*)(F.U() + UC_FQ), (const attn_body::bf16*)(F.U() + UC_FK), (const attn_body::bf16*)(F.U() + UC_FV), (const attn_body::bf16*)(F.U() + UC_FZ),
                                        (attn_body::bf16*)F.MIX(), (char*)lds, F.Gt(), F.fox_fb[l * 6 + h]); }
            else
#endif
#ifndef NO_MEM
            { const int j = it - 1408; mem_item(F, l, j >> 6, (j >> 4) & 3, j & 15); }
#else
            {}
#endif
        }
        grid.sync();
#ifndef NO_ML3
        for (int it = F.bid; it < 1024; it += F.G) ml_item3(F, l, it & 15, it >> 4);
#endif
        grid.sync();
        { pg8::Gemm g{F.MIX(), F.WoutT() + (size_t)l * 1024 * 1024, M, DMODEL, 1024}; pg8::StaticOrder S; S.init(M, DMODEL, F.G, F.bid); pg8::EpiF32 E{F.Y(), DMODEL};
          pg8::gemm_phase<pg8::EpiF32, pg8::StaticOrder, false, true>(F.lds, g, S, E); }
        grid.sync();
        ln_phase(F, l == 0 ? F.x : F.out, F.ln_g + l * DMODEL, F.ln_b + l * DMODEL);
        grid.sync();
    }
}

extern "C" void kernel_launch(void* const* d_in, const int* in_sizes, int n_in, void* d_out, int out_size, void* d_ws, size_t ws_size, hipStream_t stream) {
    static int grid = 0;
    if (grid == 0) {
        if (n_in != 13 || out_size != M * DMODEL || ws_size < WS_END) { fprintf(stderr, "kernel_launch: unexpected shapes (n_in %d out %d ws %zu)\n", n_in, out_size, ws_size); grid = -1; return; }
        int dev = 0, cus = 0, per_cu = 0;
        hipGetDevice(&dev); hipDeviceGetAttribute(&cus, hipDeviceAttributeMultiprocessorCount, dev);
        if (hipFuncSetAttribute((const void*)hybrid_fwd, hipFuncAttributeMaxDynamicSharedMemorySize, LDS_BYTES) != hipSuccess) { fprintf(stderr, "kernel_launch: hipFuncSetAttribute failed\n"); grid = -1; return; }
        if (hipOccupancyMaxActiveBlocksPerMultiprocessor(&per_cu, (const void*)hybrid_fwd, NTHR, LDS_BYTES) != hipSuccess || per_cu < 1) { fprintf(stderr, "kernel_launch: occupancy query says %d\n", per_cu); per_cu = 1; }
        (void)hipGetLastError();
        grid = cus;
    }
    if (grid < 0) return;
    hipMemsetAsync((char*)d_ws + WS_CTL, 0, CTL_ZERO_BYTES, stream);
    Args a{};
    for (int i = 0; i < 13; ++i) a.in[i] = (const float*)d_in[i];
    a.out = (float*)d_out; a.ws = (unsigned char*)d_ws;
    void* kargs[] = {&a};
    hipError_t e = hipLaunchCooperativeKernel((const void*)hybrid_fwd, dim3(grid), dim3(NTHR), kargs, LDS_BYTES, stream);
    if (e != hipSuccess) fprintf(stderr, "cooperative launch failed: %s (grid %d)\n", hipGetErrorString(e), grid);
}
```
